# Optimizing an MI355X kernel written in HIP

```python
import math
import jax, jax.numpy as jnp
from jax import lax
import numpy as np

D_MODEL = 1024
BATCH = 8
SEQ = 8192
DEPTH = 2
DEC_BATCH = 4
DEC_SEQ = 4096
PAST_LEN = 128

GRID_W = 64
N_MIXERS = 2
N_POOL_LAYERS = (DEPTH + 1) // 2
N_NA_LAYERS = DEPTH // 2
POOL_EXPAND = 2
POOL_WIDTH = POOL_EXPAND * D_MODEL
POOL_WINDOWS = (2, 4, 8, 16)
N_POOL_GROUPS = len(POOL_WINDOWS)
POOL_GROUP_W = POOL_WIDTH // N_POOL_GROUPS
NA_WIDTH = D_MODEL
NA_HEAD_DIM = 32
NA_HEADS = NA_WIDTH // NA_HEAD_DIM
WIN_H = 8
WIN_W = 16
NA_SCALE = NA_HEAD_DIM ** -0.5
LN_EPS = 1e-5
DEEPNORM_ALPHA = (2 * DEPTH) ** 0.25
DEEPNORM_BETA = (8 * DEPTH) ** -0.25

kernel_name = 'hybrid_pool_natten_deepnorm_encoder'


def layer_norm(x, g, b):
    x32 = x.astype(jnp.float32)
    mu = jnp.mean(x32, axis=-1, keepdims=True)
    var = jnp.mean(jnp.square(x32 - mu), axis=-1, keepdims=True)
    y = (x32 - mu) * lax.rsqrt(var + LN_EPS) * g.astype(jnp.float32) + b.astype(jnp.float32)
    return y.astype(x.dtype)


def centred_mean_minus_self(u, w):
    seq = u.shape[1]
    h = w // 2
    u32 = u.astype(jnp.float32)
    cs = jnp.pad(jnp.cumsum(u32, axis=1), ((0, 0), (1, 0), (0, 0)))
    ext = jnp.pad(cs, ((0, 0), (h, h), (0, 0)), mode='edge')
    t = jnp.arange(seq)
    cnt = (jnp.minimum(t + h, seq) - jnp.maximum(t - h, 0)).astype(jnp.float32)
    mean = (ext[:, w:w + seq] - ext[:, :seq]) / cnt[None, :, None]
    return (mean - u32).astype(u.dtype)


def pool_branch(x, w_in, w_grp, scale, w_out):
    bsz, seq, _ = x.shape
    u, gate = jnp.split(x @ w_in, 2, axis=-1)
    ug = u.reshape(bsz, seq, N_POOL_GROUPS, POOL_GROUP_W)
    mixed = jnp.stack([centred_mean_minus_self(ug[:, :, i], POOL_WINDOWS[i])
                       for i in range(N_POOL_GROUPS)], axis=2)
    y = jnp.einsum('bsgc,gcd->bsgd', mixed, w_grp).reshape(bsz, seq, POOL_WIDTH) * scale
    return (y * jax.nn.silu(gate)) @ w_out


def neighbourhood_attention(q, k, v, rpb):
    bsz, seq = q.shape[0], q.shape[1]
    rows = seq // GRID_W
    kh = min(WIN_H, rows)
    row_start = np.clip(np.arange(rows) - kh // 2, 0, rows - kh)
    col_start = np.clip(np.arange(GRID_W) - WIN_W // 2, 0, GRID_W - WIN_W)
    col_idx = col_start[:, None] + np.arange(WIN_W)[None, :]
    dc = col_idx - np.arange(GRID_W)[:, None] + (WIN_W - 1)
    dr = row_start[:, None] + np.arange(kh)[None, :] - np.arange(rows)[:, None] + (WIN_H - 1)
    grid = lambda t: t.reshape(bsz, rows, GRID_W, NA_HEADS, NA_HEAD_DIM)
    qg, kg, vg = grid(q), grid(k), grid(v)
    rpb32 = rpb.astype(jnp.float32)

    def row_block(args):
        q_r, r0, dr_r = args
        k_w = lax.dynamic_slice_in_dim(kg, r0, kh, axis=1)[:, :, col_idx]
        v_w = lax.dynamic_slice_in_dim(vg, r0, kh, axis=1)[:, :, col_idx]
        s = jnp.einsum('bqhd,biqjhd->bhqij', q_r, k_w).astype(jnp.float32) * NA_SCALE
        bias = jnp.take(rpb32, dr_r, axis=1)[:, :, dc]
        s = s + jnp.transpose(bias, (0, 2, 1, 3))[None]
        p = jax.nn.softmax(s.reshape(bsz, NA_HEADS, GRID_W, kh * WIN_W), axis=-1).reshape(s.shape)
        return jnp.einsum('bhqij,biqjhd->bqhd', p.astype(v_w.dtype), v_w)

    out = lax.map(row_block, (jnp.moveaxis(qg, 1, 0),
                              jnp.asarray(row_start, dtype=jnp.int32),
                              jnp.asarray(dr, dtype=jnp.int32)))
    return jnp.moveaxis(out, 0, 1).reshape(bsz, seq, NA_WIDTH)


def na_branch(x, w_in, rpb, w_out):
    bsz, seq, _ = x.shape
    q, k, v, gate = jnp.split(x @ w_in, 4, axis=-1)
    heads = lambda t: t.reshape(bsz, seq, NA_HEADS, NA_HEAD_DIM)
    o = neighbourhood_attention(heads(q), heads(k), heads(v), rpb)
    return (o * jax.nn.silu(gate)) @ w_out


def trunk(x, w_in_pool, w_grp_pool, scale_pool, w_out_pool, w_in_na, rpb_na, w_out_na, ln_g, ln_b):
    for i in range(DEPTH):
        j = i // N_MIXERS
        if i % N_MIXERS == 0:
            h = pool_branch(x, w_in_pool[j], w_grp_pool[j], scale_pool[j], w_out_pool[j])
        else:
            h = na_branch(x, w_in_na[j], rpb_na[j], w_out_na[j])
        x = layer_norm(DEEPNORM_ALPHA * x + h, ln_g[i], ln_b[i])
    return x


def setup_inputs(seed: int = 0) -> dict:
    key = jax.random.key(seed)
    ks = jax.random.split(key, 11)
    f32 = jnp.float32
    nrm = lambda k, shape: jax.random.normal(k, shape, dtype=f32)
    return {
        'x_prompt': nrm(ks[0], (BATCH, SEQ, D_MODEL)),
        'x_sample': nrm(ks[1], (DEC_BATCH, DEC_SEQ, D_MODEL)),
        'w_in_pool': nrm(ks[2], (N_POOL_LAYERS, D_MODEL, 2 * POOL_WIDTH)) * D_MODEL ** -0.5,
        'w_grp_pool': nrm(ks[3], (N_POOL_LAYERS, N_POOL_GROUPS, POOL_GROUP_W, POOL_GROUP_W)) * POOL_GROUP_W ** -0.5,
        'scale_pool': 1.0 + 0.02 * nrm(ks[4], (N_POOL_LAYERS, POOL_WIDTH)),
        'w_out_pool': nrm(ks[5], (N_POOL_LAYERS, POOL_WIDTH, D_MODEL)) * (POOL_WIDTH ** -0.5 * DEEPNORM_BETA),
        'w_in_na': nrm(ks[6], (N_NA_LAYERS, D_MODEL, 4 * NA_WIDTH)) * D_MODEL ** -0.5,
        'rpb_na': 0.1 * nrm(ks[7], (N_NA_LAYERS, NA_HEADS, 2 * WIN_H - 1, 2 * WIN_W - 1)),
        'w_out_na': nrm(ks[8], (N_NA_LAYERS, NA_WIDTH, D_MODEL)) * (NA_WIDTH ** -0.5 * DEEPNORM_BETA),
        'ln_g': 1.0 + 0.02 * nrm(ks[9], (DEPTH, D_MODEL)),
        'ln_b': 0.02 * nrm(ks[10], (DEPTH, D_MODEL)),
    }


def reference(x_prompt, x_sample, w_in_pool, w_grp_pool, scale_pool, w_out_pool,
              w_in_na, rpb_na, w_out_na, ln_g, ln_b):
    y_prompt = trunk(x_prompt, w_in_pool, w_grp_pool, scale_pool, w_out_pool,
                     w_in_na, rpb_na, w_out_na, ln_g, ln_b)
    y_sample = trunk(x_sample, w_in_pool, w_grp_pool, scale_pool, w_out_pool,
                     w_in_na, rpb_na, w_out_na, ln_g, ln_b)
    return (y_prompt, y_sample)
```

```cpp
#include <hip/hip_runtime.h>
#include <hip/hip_cooperative_groups.h>
#include <cstdio>
#include <cstdint>
namespace cg = cooperative_groups;

#ifndef MK_ONE_LAUNCH
#define MK_ONE_LAUNCH 1
#endif

#define LAS __attribute__((address_space(3)))
typedef unsigned short bf16_t;
typedef short bf16x8 __attribute__((ext_vector_type(8)));
typedef float f32x4 __attribute__((ext_vector_type(4)));
typedef float f32x2 __attribute__((ext_vector_type(2)));
typedef unsigned u32x4 __attribute__((ext_vector_type(4)));
typedef unsigned u32x2 __attribute__((ext_vector_type(2)));
typedef __bf16 bf2_t __attribute__((ext_vector_type(2)));

constexpr int D = 1024;
constexpr int TP = 8 * 8192, TS = 4 * 4096, T = TP + TS;
constexpr int PW = 2048;
constexpr int NHEAD = 32, HD = 32;
constexpr float LN_EPS = 1e-5f;
constexpr float DN_ALPHA = 1.4142135623730951f;
constexpr float LOG2E = 1.4426950408889634f;
constexpr float NA_QSCALE = 0.17677669529663687f * LOG2E;
constexpr int NTHREADS = 512, NWAVES = 8;
constexpr int LDS_BYTES = 131072;

constexpr size_t MiB = 1u << 20;
constexpr size_t WS_R0 = 0;
constexpr size_t WS_R1 = 160 * MiB;
constexpr size_t WS_R2 = 480 * MiB;
constexpr size_t WS_W1 = 800 * MiB;
constexpr size_t WS_W2 = 808 * MiB;
constexpr size_t WS_W3 = 810 * MiB;
constexpr size_t WS_W4 = 814 * MiB;
constexpr size_t WS_W5 = 822 * MiB;
constexpr size_t WS_END = 824 * MiB;

__device__ __forceinline__ unsigned pk2(float lo, float hi) { f32x2 v = {lo, hi}; bf2_t r = __builtin_convertvector(v, bf2_t); return __builtin_bit_cast(unsigned, r); }
__device__ __forceinline__ float bf_lo(unsigned w) { return __builtin_bit_cast(float, w << 16); }
__device__ __forceinline__ float bf_hi(unsigned w) { return __builtin_bit_cast(float, w & 0xffff0000u); }
__device__ __forceinline__ float silu_f(float x) { return x * __builtin_amdgcn_rcpf(1.0f + __builtin_amdgcn_exp2f(-LOG2E * x)); }
__device__ __forceinline__ float wave_sum(float v) {
#pragma unroll
    for (int o = 1; o < 64; o <<= 1) v += __shfl_xor(v, o);
    return v;
}
#define LDS_WAIT() asm volatile("s_waitcnt lgkmcnt(0)" ::: "memory")

namespace pg8 {
constexpr int BM = 256, BK = 64, HALF = 128, HTB = HALF * BK * 2, STAGE_BYTES = 8 * HTB, NXCD = 8, WGM = 8;
__host__ __device__ __forceinline__ int lds_byte(int r, int c) { const int st = (r >> 4) * 2 + (c >> 5), rr = r & 15, cc = c & 31, ob = rr * 64 + cc * 2; return st * 1024 + (ob ^ (((ob >> 9) & 1) << 5)); }
__host__ __device__ __forceinline__ void stage_rc(int b, int& R, int& C) { const int st = b / 1024, sb = b % 1024, swz = sb ^ (((sb >> 9) & 1) << 5); R = (st >> 1) * 16 + swz / 64; C = (st & 1) * 32 + (swz % 64) / 2; }
__host__ __device__ __forceinline__ int perm32(int rho) { const int n = rho >> 4, i = rho & 15; return 8 * (i >> 2) + 4 * n + (i & 3); }

struct Unit { int pm, pn; };
struct Gemm { const bf16_t* A; const bf16_t* Bt; int M, N, K, lda, ldb, grp_tiles; };

struct StaticOrder {
    int nM, nN, nwg, G, c;
    __host__ __device__ void init(int M, int N, int G_, int c_) { nM = M / BM; nN = N / BM; nwg = nM * nN; G = G_; c = c_; }
    __host__ __device__ bool next(int i, Unit& u) const {
        const long L = (long)i * G + c; if (L >= nwg) return false;
        int wgid = (int)L; { const int q = nwg / NXCD, r = nwg % NXCD, xcd = wgid % NXCD, off = wgid / NXCD; wgid = (xcd < r ? xcd * (q + 1) : r * (q + 1) + (xcd - r) * q) + off; }
        const int nig = WGM * nN, gid = wgid / nig, fm = gid * WGM, gsz = (nM - fm) < WGM ? (nM - fm) : WGM;
        u.pm = fm + ((wgid % nig) % gsz); u.pn = (wgid % nig) / gsz; return true;
    }
};

struct EpiBf16 {
    static constexpr bool PERM = true;
    bf16_t* O0; long d1, d2; int ldc; int split_tiles; int silu_t; float scale0;
    __device__ __forceinline__ void operator()(const f32x4 (&acc)[2][2][4][2], const Unit& u, int wr, int wc, int fr, int fq) const {
        const int t = u.pn / split_tiles; const int colt = (u.pn - t * split_tiles) * BM;
        bf16_t* base = O0 + (long)(t == 1) * d1 + (long)(t == 2) * d2;
        const float sc = t == 0 ? scale0 : 1.0f; const bool act = (t == silu_t);
        const int row0 = u.pm * BM + wr * 64 + fr, col0 = colt + wc * 32 + 8 * fq;
#pragma unroll
        for (int ai = 0; ai < 2; ++ai)
#pragma unroll
            for (int m = 0; m < 4; ++m) { bf16_t* rowp = base + (size_t)(row0 + ai * HALF + m * 16) * ldc + col0;
#pragma unroll
                for (int bj = 0; bj < 2; ++bj) { f32x4 v0 = acc[ai][bj][m][0] * sc, v1 = acc[ai][bj][m][1] * sc;
                    if (act) {
#pragma unroll
                        for (int j = 0; j < 4; ++j) { v0[j] = silu_f(v0[j]); v1[j] = silu_f(v1[j]); } }
                    u32x4 w; w.x = pk2(v0[0], v0[1]); w.y = pk2(v0[2], v0[3]); w.z = pk2(v1[0], v1[1]); w.w = pk2(v1[2], v1[3]);
                    *(u32x4*)(rowp + bj * HALF) = w; } }
    }
};
struct EpiGate {
    static constexpr bool PERM = true;
    bf16_t* Z; const bf16_t* SG; const float* scale; int ldc;
    __device__ __forceinline__ void operator()(const f32x4 (&acc)[2][2][4][2], const Unit& u, int wr, int wc, int fr, int fq) const {
        const int row0 = u.pm * BM + wr * 64 + fr, col0 = u.pn * BM + wc * 32 + 8 * fq;
        f32x4 sv[2][2];
#pragma unroll
        for (int bj = 0; bj < 2; ++bj)
#pragma unroll
            for (int n = 0; n < 2; ++n) sv[bj][n] = *(const f32x4*)(scale + col0 + bj * HALF + 4 * n);
#pragma unroll
        for (int ai = 0; ai < 2; ++ai)
#pragma unroll
            for (int m = 0; m < 4; ++m) { const size_t off = (size_t)(row0 + ai * HALF + m * 16) * ldc + col0;
#pragma unroll
                for (int bj = 0; bj < 2; ++bj) { const u32x4 g = *(const u32x4*)(SG + off + bj * HALF);
                    f32x4 v0 = acc[ai][bj][m][0] * sv[bj][0], v1 = acc[ai][bj][m][1] * sv[bj][1];
                    v0[0] *= bf_lo(g.x); v0[1] *= bf_hi(g.x); v0[2] *= bf_lo(g.y); v0[3] *= bf_hi(g.y);
                    v1[0] *= bf_lo(g.z); v1[1] *= bf_hi(g.z); v1[2] *= bf_lo(g.w); v1[3] *= bf_hi(g.w);
                    u32x4 w; w.x = pk2(v0[0], v0[1]); w.y = pk2(v0[2], v0[3]); w.z = pk2(v1[0], v1[1]); w.w = pk2(v1[2], v1[3]);
                    *(u32x4*)(Z + off + bj * HALF) = w; } }
    }
};
struct EpiRes {
    static constexpr bool PERM = false;
    float* Y; const float* res0; const float* res1; int rsplit; int ldc;
    __device__ __forceinline__ void operator()(const f32x4 (&acc)[2][2][4][2], const Unit& u, int wr, int wc, int fr, int fq) const {
        const int row0 = u.pm * BM + wr * 64 + fr, col0 = u.pn * BM + wc * 32 + 4 * fq;
        const float* rb = (u.pm * BM < rsplit) ? res0 : res1 - (size_t)rsplit * ldc;
#pragma unroll
        for (int ai = 0; ai < 2; ++ai)
#pragma unroll
            for (int m = 0; m < 4; ++m) { const size_t off = (size_t)(row0 + ai * HALF + m * 16) * ldc + col0;
#pragma unroll
                for (int bj = 0; bj < 2; ++bj)
#pragma unroll
                    for (int n = 0; n < 2; ++n) { const f32x4 r = *(const f32x4*)(rb + off + bj * HALF + n * 16);
                        *(f32x4*)(Y + off + bj * HALF + n * 16) = r * DN_ALPHA + acc[ai][bj][m][n]; }
                asm volatile("" ::: "memory"); }
    }
};

template <class Epi, bool ALIGN_EPI = true>
__device__ __forceinline__ void gemm_phase(LAS unsigned char* lds, const Gemm g, const StaticOrder& S, const Epi& E) {
    const int tid = threadIdx.x, wid = __builtin_amdgcn_readfirstlane(tid >> 6), lane = tid & 63, wr = wid >> 2, wc = wid & 3, fr = lane & 15, fq = lane >> 4;
    const int K = g.K, nt = K / BK;
    unsigned voffA[2], voffB[2];
#pragma unroll
    for (int i = 0; i < 2; ++i) { int R, C; stage_rc(tid * 16 + i * 8192, R, C); const int Rb = Epi::PERM ? ((R & ~31) + perm32(R & 31)) : R;
        voffA[i] = (unsigned)(R * g.lda + C) * 2u; voffB[i] = (unsigned)(Rb * g.ldb + C) * 2u; }
    const size_t kstep = (size_t)(BK * 2);
    const size_t hstepA = (size_t)HALF * g.lda * 2, hstepB = (size_t)HALF * g.ldb * 2;
    const size_t tstepA = 2 * hstepA, tstepB = 2 * hstepB;
    const unsigned ldsw = (unsigned)wid * 1024u;
    const int aoff = lds_byte(wr * 64 + fr, fq * 8), boff = lds_byte(wc * 32 + fr, fq * 8);
#define PG8_SA(b, h) (((b) * 2 + (h)) * HTB)
#define PG8_SB(b, h) ((4 + (b) * 2 + (h)) * HTB)
#define PG8_STAGE(bufoff, gbase, voff) do { _Pragma("unroll") for (int _i = 0; _i < 2; ++_i) \
        __builtin_amdgcn_global_load_lds((const unsigned*)((const char*)(gbase) + (voff)[_i]), (LAS unsigned*)(lds + (bufoff) + ldsw + _i * 8192), 16, 0, 0); } while (0)
#define PG8_LDA(dst, b, h) do { _Pragma("unroll") for (int m = 0; m < 4; ++m) _Pragma("unroll") for (int k = 0; k < 2; ++k) dst[m][k] = *(const LAS bf16x8*)(lds + PG8_SA(b, h) + aoff + m * 2048 + k * 1024); } while (0)
#define PG8_LDB(dst, b, h) do { _Pragma("unroll") for (int n = 0; n < 2; ++n) _Pragma("unroll") for (int k = 0; k < 2; ++k) dst[n][k] = *(const LAS bf16x8*)(lds + PG8_SB(b, h) + boff + n * 2048 + k * 1024); } while (0)
#define PG8_MMA(ai, bj, At, Bt) do { __builtin_amdgcn_s_setprio(1); _Pragma("unroll") for (int m = 0; m < 4; ++m) _Pragma("unroll") for (int n = 0; n < 2; ++n) _Pragma("unroll") for (int k = 0; k < 2; ++k) \
        acc[ai][bj][m][n] = __builtin_amdgcn_mfma_f32_16x16x32_bf16(Bt[n][k], At[m][k], acc[ai][bj][m][n], 0, 0, 0); __builtin_amdgcn_s_setprio(0); } while (0)
#define PG8_WAIT_V(n) asm volatile("s_waitcnt vmcnt(" #n ")" ::: "memory")
#define PG8_WAIT_L(n) asm volatile("s_waitcnt lgkmcnt(" #n ")" ::: "memory")
#define PG8_BAR __builtin_amdgcn_s_barrier()
#define PG8_SCHED __builtin_amdgcn_sched_barrier(0)
    Unit cur, nxt; int ui = 0;
    if (!S.next(0, cur)) return;
    f32x4 acc[2][2][4][2];
#pragma unroll
    for (int a = 0; a < 2; ++a)
#pragma unroll
        for (int b = 0; b < 2; ++b)
#pragma unroll
            for (int m = 0; m < 4; ++m)
#pragma unroll
                for (int n = 0; n < 2; ++n) acc[a][b][m][n] = (f32x4){0.f, 0.f, 0.f, 0.f};
    bf16x8 At[4][2], B0[2][2], B1[2][2];
    const char* cA = (const char*)g.A + (size_t)cur.pm * tstepA + (size_t)(cur.pn / g.grp_tiles) * K * 2; const char* cB = (const char*)g.Bt + (size_t)cur.pn * tstepB;
    PG8_STAGE(PG8_SB(0, 0), cB, voffB); PG8_STAGE(PG8_SB(0, 1), cB + hstepB, voffB); PG8_STAGE(PG8_SA(0, 0), cA, voffA); PG8_STAGE(PG8_SA(0, 1), cA + hstepA, voffA);
    if (wr == 1) PG8_BAR;
    PG8_WAIT_V(2); PG8_BAR;
    PG8_STAGE(PG8_SB(1, 0), cB + kstep, voffB); PG8_STAGE(PG8_SA(1, 0), cA + kstep, voffA); PG8_STAGE(PG8_SB(1, 1), cB + hstepB + kstep, voffB);
    PG8_WAIT_V(6); PG8_BAR;
    for (;;) {
        const bool has_next = S.next(ui + 1, nxt);
        const char* nA = has_next ? (const char*)g.A + (size_t)nxt.pm * tstepA + (size_t)(nxt.pn / g.grp_tiles) * K * 2 : cA; const char* nB = has_next ? (const char*)g.Bt + (size_t)nxt.pn * tstepB : cB;
        for (int t = 0; t < nt; t += 2) {
            const bool last = (t == nt - 2);
            const char* a1 = cA + (size_t)(t + 1) * kstep;
            const char* a2 = last ? nA : cA + (size_t)(t + 2) * kstep; const char* b2 = last ? nB : cB + (size_t)(t + 2) * kstep;
            const char* a3 = a2 + kstep; const char* b3 = b2 + kstep;
            PG8_LDB(B0, 0, 0); PG8_LDB(B1, 0, 1); PG8_SCHED; PG8_LDA(At, 0, 0); PG8_STAGE(PG8_SA(1, 1), a1 + hstepA, voffA);
            PG8_WAIT_V(8); PG8_WAIT_L(0); PG8_BAR; PG8_MMA(0, 0, At, B0); PG8_MMA(0, 1, At, B1); PG8_BAR; PG8_SCHED;
            PG8_LDA(At, 0, 1); PG8_STAGE(PG8_SB(0, 0), b2, voffB); PG8_STAGE(PG8_SB(0, 1), b2 + hstepB, voffB); PG8_STAGE(PG8_SA(0, 0), a2, voffA);
            PG8_WAIT_V(8); PG8_WAIT_L(0); PG8_BAR; PG8_MMA(1, 0, At, B0); PG8_MMA(1, 1, At, B1); PG8_BAR; PG8_SCHED;
            PG8_LDB(B0, 1, 0); PG8_LDB(B1, 1, 1); PG8_SCHED; PG8_LDA(At, 1, 0); PG8_STAGE(PG8_SA(0, 1), a2 + hstepA, voffA);
            PG8_WAIT_V(8); PG8_WAIT_L(0); PG8_BAR; PG8_MMA(0, 0, At, B0); PG8_MMA(0, 1, At, B1); PG8_BAR; PG8_SCHED;
            PG8_LDA(At, 1, 1); PG8_STAGE(PG8_SB(1, 0), b3, voffB); PG8_STAGE(PG8_SB(1, 1), b3 + hstepB, voffB); PG8_STAGE(PG8_SA(1, 0), a3, voffA);
            PG8_WAIT_V(8); PG8_WAIT_L(0); PG8_BAR; PG8_MMA(1, 0, At, B0); PG8_MMA(1, 1, At, B1); PG8_BAR; PG8_SCHED;
        }
        if constexpr (ALIGN_EPI) { if (wr == 0) PG8_BAR; }
        E(acc, cur, wr, wc, fr, fq);
        if (!has_next) break;
#pragma unroll
        for (int a = 0; a < 2; ++a)
#pragma unroll
            for (int b = 0; b < 2; ++b)
#pragma unroll
                for (int m = 0; m < 4; ++m)
#pragma unroll
                    for (int n = 0; n < 2; ++n) acc[a][b][m][n] = (f32x4){0.f, 0.f, 0.f, 0.f};
        cur = nxt; cA = nA; cB = nB; ++ui;
        if constexpr (ALIGN_EPI) { if (wr == 1) PG8_BAR; }
    }
    PG8_WAIT_V(0);
    if constexpr (!ALIGN_EPI) { if (wr == 0) PG8_BAR; }
    PG8_BAR;
#undef PG8_SA
#undef PG8_SB
#undef PG8_STAGE
#undef PG8_LDA
#undef PG8_LDB
#undef PG8_MMA
#undef PG8_WAIT_V
#undef PG8_WAIT_L
#undef PG8_BAR
#undef PG8_SCHED
}
}

__device__ __forceinline__ void transpose_item(const float* W, int K, int N, bf16_t* WT, int row_base, LAS float* scr, int kb, int nb, int lane) {
    const int k0 = 64 * kb, n0 = 32 * nb;
#pragma unroll 8
    for (int i = 0; i < 32; ++i) { const int kk = 2 * i + (lane >> 5); scr[kk * 33 + (lane & 31)] = W[(size_t)(k0 + kk) * N + n0 + (lane & 31)]; }
    LDS_WAIT();
    const int c = lane & 7;
#pragma unroll
    for (int j = 0; j < 4; ++j) { const int n = (lane >> 3) + 8 * j; const LAS float* s = scr + (8 * c) * 33 + n;
        u32x4 o; o.x = pk2(s[0 * 33], s[1 * 33]); o.y = pk2(s[2 * 33], s[3 * 33]); o.z = pk2(s[4 * 33], s[5 * 33]); o.w = pk2(s[6 * 33], s[7 * 33]);
        *(u32x4*)(WT + (size_t)(row_base + n) * K + k0 + 8 * c) = o; }
    LDS_WAIT();
}

struct Ptrs {
    const float *xp, *xs, *w_in_pool, *w_grp, *scale_pool, *w_out_pool, *w_in_na, *rpb, *w_out_na, *ln_g, *ln_b;
    float* out; unsigned char* ws;
};

__device__ __forceinline__ void p0_convert(const Ptrs& P, LAS unsigned char* lds, int vcu, int G, int wave, int lane) {
    LAS float* scr = (LAS float*)(lds + wave * 16384);
    const int gw = vcu * NWAVES + wave, NGW = G * NWAVES;
    bf16_t* Wt1 = (bf16_t*)(P.ws + WS_W1); bf16_t* Wt2 = (bf16_t*)(P.ws + WS_W2); bf16_t* Wt3 = (bf16_t*)(P.ws + WS_W3); bf16_t* Wt4 = (bf16_t*)(P.ws + WS_W4); bf16_t* Wt5 = (bf16_t*)(P.ws + WS_W5);
    constexpr int I1 = 16 * 128, I2 = 4 * 8 * 16, I3 = 32 * 32, I4 = 16 * 128, I5 = 16 * 32;
    constexpr int NITEMS = I1 + I2 + I3 + I4 + I5;
    for (int it = gw; it < NITEMS; it += NGW) {
        int r = it;
        if (r < I1) { transpose_item(P.w_in_pool, 1024, 4096, Wt1, 32 * (r % 128), scr, r / 128, r % 128, lane); continue; } r -= I1;
        if (r < I2) { const int g = r / 128, q = r % 128; transpose_item(P.w_grp + (size_t)g * 512 * 512, 512, 512, Wt2 + (size_t)g * 512 * 512, 32 * (q % 16), scr, q / 16, q % 16, lane); continue; } r -= I2;
        if (r < I3) { transpose_item(P.w_out_pool, 2048, 1024, Wt3, 32 * (r % 32), scr, r / 32, r % 32, lane); continue; } r -= I3;
        if (r < I4) { const int nb = r % 128, n0 = 32 * nb; const int rb = n0 < 2048 ? n0 : (n0 < 3072 ? n0 + 1024 : n0 - 1024);
            transpose_item(P.w_in_na, 1024, 4096, Wt4, rb, scr, r / 128, nb, lane); continue; } r -= I4;
        transpose_item(P.w_out_na, 1024, 1024, Wt5, 32 * (r % 32), scr, r / 32, r % 32, lane);
    }
    bf16_t* xb = (bf16_t*)(P.ws + WS_R0);
    const size_t nitem = (size_t)T * D / 8, gt = (size_t)(vcu * NTHREADS + wave * 64 + lane), NGT = (size_t)G * NTHREADS;
    for (size_t i = gt; i < nitem; i += NGT) {
        const size_t e = i * 8; const float* src = e < (size_t)TP * D ? P.xp + e : P.xs + (e - (size_t)TP * D);
        const f32x4 a = *(const f32x4*)src, b = *(const f32x4*)(src + 4);
        u32x4 o; o.x = pk2(a[0], a[1]); o.y = pk2(a[2], a[3]); o.z = pk2(b[0], b[1]); o.w = pk2(b[2], b[3]);
        *(u32x4*)(xb + e) = o;
    }
}

__device__ __forceinline__ void load8(const bf16_t* p, float (&v)[8]) { const u32x4 w = *(const u32x4*)p; v[0] = bf_lo(w.x); v[1] = bf_hi(w.x); v[2] = bf_lo(w.y); v[3] = bf_hi(w.y); v[4] = bf_lo(w.z); v[5] = bf_hi(w.z); v[6] = bf_lo(w.w); v[7] = bf_hi(w.w); }
__device__ __forceinline__ void pool_phase(const bf16_t* u, bf16_t* mx, int vcu, int G, int tid) {
    constexpr int CH = 32;
    const int sub = tid >> 8, t8 = tid & 255, g = t8 >> 6, h = 1 << g, c0 = t8 * 8;
    for (int ck = vcu * 2 + sub; ck < T / CH; ck += G * 2) {
        const int t0 = ck * CH;
        int s0, s1; if (t0 < TP) { s0 = t0 & ~8191; s1 = s0 + 8192; } else { s0 = TP + ((t0 - TP) & ~4095); s1 = s0 + 4096; }
        float sum[8], v[8];
#pragma unroll
        for (int j = 0; j < 8; ++j) sum[j] = 0.f;
        const int lo = max(t0 - h, s0), hi = min(t0 + h, s1);
        for (int k = lo; k < hi; ++k) { load8(u + (size_t)k * PW + c0, v);
#pragma unroll
            for (int j = 0; j < 8; ++j) sum[j] += v[j]; }
        for (int t = t0; t < t0 + CH; ++t) {
            const int wl = max(t - h, s0), wh = min(t + h, s1); const float inv = 1.0f / (float)(wh - wl);
            load8(u + (size_t)t * PW + c0, v);
            u32x4 o; o.x = pk2(sum[0] * inv - v[0], sum[1] * inv - v[1]); o.y = pk2(sum[2] * inv - v[2], sum[3] * inv - v[3]);
            o.z = pk2(sum[4] * inv - v[4], sum[5] * inv - v[5]); o.w = pk2(sum[6] * inv - v[6], sum[7] * inv - v[7]);
            *(u32x4*)(mx + (size_t)t * PW + c0) = o;
            if (t + h < s1) { load8(u + (size_t)(t + h) * PW + c0, v);
#pragma unroll
                for (int j = 0; j < 8; ++j) sum[j] += v[j]; }
            if (t - h >= s0) { load8(u + (size_t)(t - h) * PW + c0, v);
#pragma unroll
                for (int j = 0; j < 8; ++j) sum[j] -= v[j]; }
        }
    }
}

__device__ __forceinline__ void ln_phase(const float* y, const float* gam, const float* bet, float* o32, bf16_t* o16, int gw, int NGW, int lane) {
    f32x4 gv[4], bv[4];
#pragma unroll
    for (int j = 0; j < 4; ++j) { gv[j] = ((const f32x4*)gam)[lane + 64 * j]; bv[j] = ((const f32x4*)bet)[lane + 64 * j]; }
    for (int row = gw; row < T; row += NGW) {
        const f32x4* yr = (const f32x4*)(y + (size_t)row * D) + lane;
        f32x4 v[4]; float s = 0.f;
#pragma unroll
        for (int j = 0; j < 4; ++j) { v[j] = yr[64 * j]; s += (v[j][0] + v[j][1]) + (v[j][2] + v[j][3]); }
        const float mean = wave_sum(s) * (1.f / D); float s2 = 0.f;
#pragma unroll
        for (int j = 0; j < 4; ++j) { v[j] = v[j] - mean; s2 += (v[j][0] * v[j][0] + v[j][1] * v[j][1]) + (v[j][2] * v[j][2] + v[j][3] * v[j][3]); }
        const float rstd = 1.f / sqrtf(wave_sum(s2) * (1.f / D) + LN_EPS);
#pragma unroll
        for (int j = 0; j < 4; ++j) { const f32x4 o = v[j] * rstd * gv[j] + bv[j];
            if (o32) ((f32x4*)(o32 + (size_t)row * D))[lane + 64 * j] = o;
            if (o16) { u32x2 w; w.x = pk2(o[0], o[1]); w.y = pk2(o[2], o[3]); ((u32x2*)(o16 + (size_t)row * D))[lane + 64 * j] = w; } }
    }
}

__device__ __forceinline__ void na_phase(LAS unsigned char* lds, const bf16_t* q, const bf16_t* k, const bf16_t* vt, const bf16_t* sg, const float* rpb, bf16_t* og, int bid, int G, int wave, int lane) {
    LAS float* btab = (LAS float*)(lds + wave * 2048) + 16;
    const int fr = lane & 15, fq = lane >> 4;
    int hprev = -1;
    for (int unit = bid; unit < 1280 * 16; unit += G) {
        const int hg = unit & 3, j = (unit >> 2) & 3, R = unit >> 4, h = hg * 8 + wave;
        int r, rows; if (R < 1024) { r = R & 127; rows = 128; } else { r = (R - 1024) & 63; rows = 64; }
        const int rs = min(max(r - 4, 0), rows - 8), Rs = R - r + rs, drb = rs - r + 7;
        if (h != hprev) { LDS_WAIT(); for (int e = lane; e < 465; e += 64) btab[e] = rpb[h * 465 + e] * LOG2E; hprev = h; LDS_WAIT(); }
        const int c = 16 * j + fr, cstart = min(max(c - 8, 0), 48);
        const int cs0 = j == 0 ? 0 : (j == 1 ? 8 : (j == 2 ? 24 : 32));
        const size_t tq = (size_t)R * 64 + c;
        const bf16x8 qv = *(const bf16x8*)(q + tq * D + h * HD + fq * 8);
        const bf16_t* kb = k + ((size_t)Rs * 64 + cs0 + fr) * D + h * HD + fq * 8;
        f32x4 S[8][2];
#pragma unroll
        for (int i = 0; i < 8; ++i)
#pragma unroll
            for (int hf = 0; hf < 2; ++hf) { const bf16x8 kv = *(const bf16x8*)(kb + (size_t)(i * 64 + hf * 16) * D);
                S[i][hf] = __builtin_amdgcn_mfma_f32_16x16x32_bf16(kv, qv, (f32x4){0.f, 0.f, 0.f, 0.f}, 0, 0, 0); }
        const int kc0 = cs0 + fq * 4, dcb = kc0 - c + 15;
        float mx = -3.0e38f;
#pragma unroll
        for (int i = 0; i < 8; ++i)
#pragma unroll
            for (int hf = 0; hf < 2; ++hf)
#pragma unroll
                for (int jj = 0; jj < 4; ++jj) { const int kc = kc0 + hf * 16 + jj; const bool valid = (kc >= cstart) && (kc < cstart + 16);
                    const float b = btab[(drb + i) * 31 + dcb + hf * 16 + jj];
                    const float s = valid ? S[i][hf][jj] + b : -3.0e38f; S[i][hf][jj] = s; mx = fmaxf(mx, s); }
        mx = fmaxf(mx, __shfl_xor(mx, 16)); mx = fmaxf(mx, __shfl_xor(mx, 32));
        float sum = 0.f;
#pragma unroll
        for (int i = 0; i < 8; ++i)
#pragma unroll
            for (int hf = 0; hf < 2; ++hf)
#pragma unroll
                for (int jj = 0; jj < 4; ++jj) { const float p = __builtin_amdgcn_exp2f(S[i][hf][jj] - mx); S[i][hf][jj] = p; sum += p; }
        sum += __shfl_xor(sum, 16); sum += __shfl_xor(sum, 32);
        f32x4 O[2] = {(f32x4){0.f, 0.f, 0.f, 0.f}, (f32x4){0.f, 0.f, 0.f, 0.f}};
        const bf16_t* vb = vt + (size_t)(h * HD + fr) * T + (size_t)Rs * 64 + cs0 + fq * 4;
#pragma unroll
        for (int i = 0; i < 8; ++i) {
            u32x4 pw; pw.x = pk2(S[i][0][0], S[i][0][1]); pw.y = pk2(S[i][0][2], S[i][0][3]); pw.z = pk2(S[i][1][0], S[i][1][1]); pw.w = pk2(S[i][1][2], S[i][1][3]);
            const bf16x8 pv = __builtin_bit_cast(bf16x8, pw);
#pragma unroll
            for (int dt = 0; dt < 2; ++dt) { const bf16_t* vp = vb + (size_t)(dt * 16) * T + i * 64;
                const u32x2 lo = *(const u32x2*)vp, hi = *(const u32x2*)(vp + 16);
                u32x4 vw; vw.x = lo.x; vw.y = lo.y; vw.z = hi.x; vw.w = hi.y;
                O[dt] = __builtin_amdgcn_mfma_f32_16x16x32_bf16(__builtin_bit_cast(bf16x8, vw), pv, O[dt], 0, 0, 0); }
        }
        const float inv = 1.0f / sum;
#pragma unroll
        for (int dt = 0; dt < 2; ++dt) { const size_t off = tq * D + h * HD + dt * 16 + fq * 4;
            const u32x2 gw = *(const u32x2*)(sg + off);
            u32x2 w; w.x = pk2(O[dt][0] * inv * bf_lo(gw.x), O[dt][1] * inv * bf_hi(gw.x)); w.y = pk2(O[dt][2] * inv * bf_lo(gw.y), O[dt][3] * inv * bf_hi(gw.y));
            *(u32x2*)(og + off) = w; }
    }
}

struct Args { const float* in[11]; float* out; unsigned char* ws; int ph_lo, ph_hi; };

__global__ void __launch_bounds__(NTHREADS, 2) mk_fwd(Args args) {
    extern __shared__ __attribute__((aligned(16))) unsigned char lds_raw[];
    LAS unsigned char* lds = (LAS unsigned char*)lds_raw;
    const int tid = threadIdx.x, lane = tid & 63, wave = __builtin_amdgcn_readfirstlane(tid >> 6);
    const int G = gridDim.x, bx = blockIdx.x;
    const int vcu = (G % 8 == 0) ? (bx % 8) * (G / 8) + bx / 8 : bx;
    Ptrs P; P.xp = args.in[0]; P.xs = args.in[1]; P.w_in_pool = args.in[2]; P.w_grp = args.in[3]; P.scale_pool = args.in[4]; P.w_out_pool = args.in[5];
    P.w_in_na = args.in[6]; P.rpb = args.in[7]; P.w_out_na = args.in[8]; P.ln_g = args.in[9]; P.ln_b = args.in[10]; P.out = args.out; P.ws = args.ws;
    unsigned char* ws = args.ws;
    bf16_t* R0 = (bf16_t*)(ws + WS_R0); bf16_t* R1 = (bf16_t*)(ws + WS_R1); bf16_t* R2 = (bf16_t*)(ws + WS_R2);
    bf16_t* OUTB = (bf16_t*)args.out;
    bf16_t* Wt1 = (bf16_t*)(ws + WS_W1); bf16_t* Wt2 = (bf16_t*)(ws + WS_W2); bf16_t* Wt3 = (bf16_t*)(ws + WS_W3); bf16_t* Wt4 = (bf16_t*)(ws + WS_W4); bf16_t* Wt5 = (bf16_t*)(ws + WS_W5);
    const int lo = args.ph_lo, hi = args.ph_hi;
#define IN(k) (lo <= (k) && (k) < hi)
#define SEAM(k) do { if (IN(k) && IN((k) + 1)) { cg::this_grid().sync(); } } while (0)
    constexpr int NOGRP = 1 << 30;

    if (IN(0)) { p0_convert(P, lds, vcu, G, wave, lane); __syncthreads(); }
    SEAM(0);
    if (IN(1)) {
        pg8::Gemm g{R0, Wt1, T, 4096, 1024, 1024, 1024, NOGRP}; pg8::StaticOrder S; S.init(T, 4096, G, bx);
        pg8::EpiBf16 E{R1, (long)(R2 - R1), 0, PW, 8, 1, 1.0f};
        pg8::gemm_phase<pg8::EpiBf16>(lds, g, S, E);
    }
    SEAM(1);
    if (IN(2)) pool_phase(R1, OUTB, vcu, G, tid);
    SEAM(2);
    if (IN(3)) {
        pg8::Gemm g{OUTB, Wt2, T, 2048, 512, PW, 512, 2}; pg8::StaticOrder S; S.init(T, 2048, G, bx);
        pg8::EpiGate E{R1, R2, P.scale_pool, PW};
        pg8::gemm_phase<pg8::EpiGate>(lds, g, S, E);
    }
    SEAM(3);
    if (IN(4)) {
        pg8::Gemm g{R1, Wt3, T, 1024, 2048, PW, 2048, NOGRP}; pg8::StaticOrder S; S.init(T, 1024, G, bx);
        pg8::EpiRes E{P.out, P.xp, P.xs, TP, D};
        pg8::gemm_phase<pg8::EpiRes>(lds, g, S, E);
    }
    SEAM(4);
    if (IN(5)) ln_phase(P.out, P.ln_g, P.ln_b, (float*)R2, R0, vcu * NWAVES + wave, G * NWAVES, lane);
    SEAM(5);
    if (IN(6)) {
        { pg8::Gemm g{R0, Wt4, T, 3072, 1024, 1024, 1024, NOGRP}; pg8::StaticOrder S; S.init(T, 3072, G, bx);
          pg8::EpiBf16 E{R1, (long)T * D, (long)(OUTB - R1), D, 4, 2, NA_QSCALE};
          pg8::gemm_phase<pg8::EpiBf16>(lds, g, S, E); }
        { pg8::Gemm g{Wt4 + (size_t)3072 * 1024, R0, 1024, T, 1024, 1024, 1024, NOGRP}; pg8::StaticOrder S; S.init(1024, T, G, bx);
          pg8::EpiBf16 E{OUTB + (size_t)T * D, 0, 0, T, NOGRP, -1, 1.0f};
          pg8::gemm_phase<pg8::EpiBf16>(lds, g, S, E); }
    }
    SEAM(6);
    if (IN(7)) na_phase(lds, R1, R1 + (size_t)T * D, OUTB + (size_t)T * D, OUTB, P.rpb, R0, bx, G, wave, lane);
    SEAM(7);
    if (IN(8)) {
        pg8::Gemm g{R0, Wt5, T, 1024, 1024, 1024, 1024, NOGRP}; pg8::StaticOrder S; S.init(T, 1024, G, bx);
        pg8::EpiRes E{P.out, (const float*)R2, (const float*)R2, 0, D};
        pg8::gemm_phase<pg8::EpiRes>(lds, g, S, E);
    }
    SEAM(8);
    if (IN(9)) ln_phase(P.out, P.ln_g + D, P.ln_b + D, P.out, nullptr, vcu * NWAVES + wave, G * NWAVES, lane);
#undef IN
#undef SEAM
}

extern "C" void kernel_launch(void* const* d_in, const int* in_sizes, int n_in, void* d_out, int out_size, void* d_ws, size_t ws_size, hipStream_t stream) {
    static int grid = 0;
    if (grid == 0) {
        if (n_in != 11 || out_size != T * D || ws_size < WS_END) { fprintf(stderr, "kernel_launch: unexpected shapes (n_in %d, out %d, ws %zu)\n", n_in, out_size, ws_size); grid = -1; return; }
        int dev = 0, cus = 0, per_cu = 0;
        hipGetDevice(&dev); hipDeviceGetAttribute(&cus, hipDeviceAttributeMultiprocessorCount, dev);
        if (hipFuncSetAttribute((const void*)mk_fwd, hipFuncAttributeMaxDynamicSharedMemorySize, LDS_BYTES) != hipSuccess) { fprintf(stderr, "kernel_launch: hipFuncSetAttribute failed\n"); grid = -1; return; }
        hipOccupancyMaxActiveBlocksPerMultiprocessor(&per_cu, (const void*)mk_fwd, NTHREADS, LDS_BYTES);
        (void)hipGetLastError();
        if (per_cu < 1) per_cu = 1;
        grid = cus * 1;
        fprintf(stderr, "kernel_launch: cus %d per_cu %d grid %d\n", cus, per_cu, grid);
    }
    if (grid < 0) return;
    Args a{};
    for (int i = 0; i < 11; ++i) a.in[i] = (const float*)d_in[i];
    a.out = (float*)d_out; a.ws = (unsigned char*)d_ws;
#if MK_ONE_LAUNCH
    a.ph_lo = 0; a.ph_hi = 10;
    void* kargs[] = {&a};
    hipError_t e = hipLaunchCooperativeKernel((const void*)mk_fwd, dim3(grid), dim3(NTHREADS), kargs, LDS_BYTES, stream);
    if (e != hipSuccess) fprintf(stderr, "kernel_launch: cooperative launch failed: %s\n", hipGetErrorString(e));
#else
    for (int ph = 0; ph < 10; ++ph) { a.ph_lo = ph; a.ph_hi = ph + 1; hipLaunchKernelGGL(mk_fwd, dim3(grid), dim3(NTHREADS), LDS_BYTES, stream, a); }
#endif
}
```

```cpp
#include <hip/hip_runtime.h>
#include <hip/hip_cooperative_groups.h>
#include <cstdio>
#include <cstdint>
namespace cg = cooperative_groups;

#ifndef MK_REP
#define MK_REP 0
#endif
#ifndef MK_ONE_LAUNCH
#define MK_ONE_LAUNCH 1
#endif

#define LAS __attribute__((address_space(3)))
typedef unsigned short bf16_t;
typedef short bf16x8 __attribute__((ext_vector_type(8)));
typedef float f32x4 __attribute__((ext_vector_type(4)));
typedef float f32x2 __attribute__((ext_vector_type(2)));
typedef unsigned u32x4 __attribute__((ext_vector_type(4)));
typedef unsigned u32x2 __attribute__((ext_vector_type(2)));
typedef __bf16 bf2_t __attribute__((ext_vector_type(2)));

constexpr int D = 1024;
constexpr int TP = 8 * 8192, TS = 4 * 4096, T = TP + TS;
constexpr int PW = 2048;
constexpr int NHEAD = 32, HD = 32;
constexpr float LN_EPS = 1e-5f;
constexpr float DN_ALPHA = 1.4142135623730951f;
constexpr float LOG2E = 1.4426950408889634f;
constexpr float NA_QSCALE = 0.17677669529663687f * LOG2E;
constexpr int NTHREADS = 512, NWAVES = 8;
constexpr int LDS_BYTES = 147456;

constexpr size_t MiB = 1u << 20;
constexpr size_t WS_R0 = 0;
constexpr size_t WS_R1 = 160 * MiB;
constexpr size_t WS_R2 = 480 * MiB;
constexpr size_t WS_W1 = 800 * MiB;
constexpr size_t WS_W2 = 808 * MiB;
constexpr size_t WS_W3 = 810 * MiB;
constexpr size_t WS_W4 = 814 * MiB;
constexpr size_t WS_W5 = 822 * MiB;
constexpr size_t WS_END = 824 * MiB;

__device__ __forceinline__ unsigned pk2(float lo, float hi) { f32x2 v = {lo, hi}; bf2_t r = __builtin_convertvector(v, bf2_t); return __builtin_bit_cast(unsigned, r); }
__device__ __forceinline__ float bf_lo(unsigned w) { return __builtin_bit_cast(float, w << 16); }
__device__ __forceinline__ float bf_hi(unsigned w) { return __builtin_bit_cast(float, w & 0xffff0000u); }
__device__ __forceinline__ float silu_f(float x) { return x * __builtin_amdgcn_rcpf(1.0f + __builtin_amdgcn_exp2f(-LOG2E * x)); }
__device__ __forceinline__ float wave_sum(float v) {
#pragma unroll
    for (int o = 1; o < 64; o <<= 1) v += __shfl_xor(v, o);
    return v;
}
#define LDS_WAIT() asm volatile("s_waitcnt lgkmcnt(0)" ::: "memory")

namespace pg8 {
constexpr int BM = 256, BK = 64, HALF = 128, HTB = HALF * BK * 2, STAGE_BYTES = 8 * HTB, NXCD = 8, WGM = 8;
__host__ __device__ __forceinline__ int lds_byte(int r, int c) { const int st = (r >> 4) * 2 + (c >> 5), rr = r & 15, cc = c & 31, ob = rr * 64 + cc * 2; return st * 1024 + (ob ^ (((ob >> 9) & 1) << 5)); }
__host__ __device__ __forceinline__ void stage_rc(int b, int& R, int& C) { const int st = b / 1024, sb = b % 1024, swz = sb ^ (((sb >> 9) & 1) << 5); R = (st >> 1) * 16 + swz / 64; C = (st & 1) * 32 + (swz % 64) / 2; }
__host__ __device__ __forceinline__ int perm32(int rho) { const int n = rho >> 4, i = rho & 15; return 8 * (i >> 2) + 4 * n + (i & 3); }

struct Unit { int pm, pn; };
struct Gemm { const bf16_t* A; const bf16_t* Bt; int M, N, K, lda, ldb, grp_tiles; };

struct StaticOrder {
    int nM, nN, nwg, G, c;
    __host__ __device__ void init(int M, int N, int G_, int c_) { nM = M / BM; nN = N / BM; nwg = nM * nN; G = G_; c = c_; }
    __host__ __device__ bool next(int i, Unit& u) const {
        const long L = (long)i * G + c; if (L >= nwg) return false;
        int wgid = (int)L; { const int q = nwg / NXCD, r = nwg % NXCD, xcd = wgid % NXCD, off = wgid / NXCD; wgid = (xcd < r ? xcd * (q + 1) : r * (q + 1) + (xcd - r) * q) + off; }
        const int nig = WGM * nN, gid = wgid / nig, fm = gid * WGM, gsz = (nM - fm) < WGM ? (nM - fm) : WGM;
        u.pm = fm + ((wgid % nig) % gsz); u.pn = (wgid % nig) / gsz; return true;
    }
};

struct EpiBf16 {
    static constexpr bool PERM = true;
    bf16_t* O0; long d1, d2; int ldc; int split_tiles; int silu_t; float scale0;
    __device__ __forceinline__ void operator()(const f32x4 (&acc)[2][2][4][2], const Unit& u, int wr, int wc, int fr, int fq) const {
        const int t = u.pn / split_tiles; const int colt = (u.pn - t * split_tiles) * BM;
        bf16_t* base = O0 + (long)(t == 1) * d1 + (long)(t == 2) * d2;
        const float sc = t == 0 ? scale0 : 1.0f; const bool act = (t == silu_t);
        const int row0 = u.pm * BM + wr * 64 + fr, col0 = colt + wc * 32 + 8 * fq;
#pragma unroll
        for (int ai = 0; ai < 2; ++ai)
#pragma unroll
            for (int m = 0; m < 4; ++m) { bf16_t* rowp = base + (size_t)(row0 + ai * HALF + m * 16) * ldc + col0;
#pragma unroll
                for (int bj = 0; bj < 2; ++bj) { f32x4 v0 = acc[ai][bj][m][0] * sc, v1 = acc[ai][bj][m][1] * sc;
                    if (act) {
#pragma unroll
                        for (int j = 0; j < 4; ++j) { v0[j] = silu_f(v0[j]); v1[j] = silu_f(v1[j]); } }
                    u32x4 w; w.x = pk2(v0[0], v0[1]); w.y = pk2(v0[2], v0[3]); w.z = pk2(v1[0], v1[1]); w.w = pk2(v1[2], v1[3]);
                    *(u32x4*)(rowp + bj * HALF) = w; } }
    }
};
struct EpiGate {
    static constexpr bool PERM = true;
    bf16_t* Z; const bf16_t* SG; const float* scale; int ldc;
    __device__ __forceinline__ void operator()(const f32x4 (&acc)[2][2][4][2], const Unit& u, int wr, int wc, int fr, int fq) const {
        const int row0 = u.pm * BM + wr * 64 + fr, col0 = u.pn * BM + wc * 32 + 8 * fq;
        f32x4 sv[2][2];
#pragma unroll
        for (int bj = 0; bj < 2; ++bj)
#pragma unroll
            for (int n = 0; n < 2; ++n) sv[bj][n] = *(const f32x4*)(scale + col0 + bj * HALF + 4 * n);
#pragma unroll
        for (int ai = 0; ai < 2; ++ai)
#pragma unroll
            for (int m = 0; m < 4; ++m) { const size_t off = (size_t)(row0 + ai * HALF + m * 16) * ldc + col0;
#pragma unroll
                for (int bj = 0; bj < 2; ++bj) { const u32x4 g = *(const u32x4*)(SG + off + bj * HALF);
                    f32x4 v0 = acc[ai][bj][m][0] * sv[bj][0], v1 = acc[ai][bj][m][1] * sv[bj][1];
                    v0[0] *= bf_lo(g.x); v0[1] *= bf_hi(g.x); v0[2] *= bf_lo(g.y); v0[3] *= bf_hi(g.y);
                    v1[0] *= bf_lo(g.z); v1[1] *= bf_hi(g.z); v1[2] *= bf_lo(g.w); v1[3] *= bf_hi(g.w);
                    u32x4 w; w.x = pk2(v0[0], v0[1]); w.y = pk2(v0[2], v0[3]); w.z = pk2(v1[0], v1[1]); w.w = pk2(v1[2], v1[3]);
                    *(u32x4*)(Z + off + bj * HALF) = w; } }
    }
};
struct EpiRes {
    static constexpr bool PERM = false;
    float* Y; const float* res0; const float* res1; int rsplit; int ldc;
    __device__ __forceinline__ void operator()(const f32x4 (&acc)[2][2][4][2], const Unit& u, int wr, int wc, int fr, int fq) const {
        const int row0 = u.pm * BM + wr * 64 + fr, col0 = u.pn * BM + wc * 32 + 4 * fq;
        const float* rb = (u.pm * BM < rsplit) ? res0 : res1 - (size_t)rsplit * ldc;
#pragma unroll
        for (int ai = 0; ai < 2; ++ai)
#pragma unroll
            for (int m = 0; m < 4; ++m) { const size_t off = (size_t)(row0 + ai * HALF + m * 16) * ldc + col0;
#pragma unroll
                for (int bj = 0; bj < 2; ++bj)
#pragma unroll
                    for (int n = 0; n < 2; ++n) { const f32x4 r = *(const f32x4*)(rb + off + bj * HALF + n * 16);
                        *(f32x4*)(Y + off + bj * HALF + n * 16) = r * DN_ALPHA + acc[ai][bj][m][n]; }
                asm volatile("" ::: "memory"); }
    }
};

template <class Epi, bool ALIGN_EPI = true>
__device__ __forceinline__ void gemm_phase(LAS unsigned char* lds, const Gemm g, const StaticOrder& S, const Epi& E) {
    const int tid = threadIdx.x, wid = __builtin_amdgcn_readfirstlane(tid >> 6), lane = tid & 63, wr = wid >> 2, wc = wid & 3, fr = lane & 15, fq = lane >> 4;
    const int K = g.K, nt = K / BK;
    unsigned voffA[2], voffB[2];
#pragma unroll
    for (int i = 0; i < 2; ++i) { int R, C; stage_rc(tid * 16 + i * 8192, R, C); const int Rb = Epi::PERM ? ((R & ~31) + perm32(R & 31)) : R;
        voffA[i] = (unsigned)(R * g.lda + C) * 2u; voffB[i] = (unsigned)(Rb * g.ldb + C) * 2u; }
    const size_t kstep = (size_t)(BK * 2);
    const size_t hstepA = (size_t)HALF * g.lda * 2, hstepB = (size_t)HALF * g.ldb * 2;
    const size_t tstepA = 2 * hstepA, tstepB = 2 * hstepB;
    const unsigned ldsw = (unsigned)wid * 1024u;
    const int aoff = lds_byte(wr * 64 + fr, fq * 8), boff = lds_byte(wc * 32 + fr, fq * 8);
#define PG8_SA(b, h) (((b) * 2 + (h)) * HTB)
#define PG8_SB(b, h) ((4 + (b) * 2 + (h)) * HTB)
#define PG8_STAGE(bufoff, gbase, voff) do { _Pragma("unroll") for (int _i = 0; _i < 2; ++_i) \
        __builtin_amdgcn_global_load_lds((const unsigned*)((const char*)(gbase) + (voff)[_i]), (LAS unsigned*)(lds + (bufoff) + ldsw + _i * 8192), 16, 0, 0); } while (0)
#define PG8_LDA(dst, b, h) do { _Pragma("unroll") for (int m = 0; m < 4; ++m) _Pragma("unroll") for (int k = 0; k < 2; ++k) dst[m][k] = *(const LAS bf16x8*)(lds + PG8_SA(b, h) + aoff + m * 2048 + k * 1024); } while (0)
#define PG8_LDB(dst, b, h) do { _Pragma("unroll") for (int n = 0; n < 2; ++n) _Pragma("unroll") for (int k = 0; k < 2; ++k) dst[n][k] = *(const LAS bf16x8*)(lds + PG8_SB(b, h) + boff + n * 2048 + k * 1024); } while (0)
#define PG8_MMA(ai, bj, At, Bt) do { __builtin_amdgcn_s_setprio(1); _Pragma("unroll") for (int m = 0; m < 4; ++m) _Pragma("unroll") for (int n = 0; n < 2; ++n) _Pragma("unroll") for (int k = 0; k < 2; ++k) \
        acc[ai][bj][m][n] = __builtin_amdgcn_mfma_f32_16x16x32_bf16(Bt[n][k], At[m][k], acc[ai][bj][m][n], 0, 0, 0); __builtin_amdgcn_s_setprio(0); } while (0)
#define PG8_WAIT_V(n) asm volatile("s_waitcnt vmcnt(" #n ")" ::: "memory")
#define PG8_WAIT_L(n) asm volatile("s_waitcnt lgkmcnt(" #n ")" ::: "memory")
#define PG8_BAR __builtin_amdgcn_s_barrier()
#define PG8_SCHED __builtin_amdgcn_sched_barrier(0)
    Unit cur, nxt; int ui = 0;
    if (!S.next(0, cur)) return;
    f32x4 acc[2][2][4][2];
#pragma unroll
    for (int a = 0; a < 2; ++a)
#pragma unroll
        for (int b = 0; b < 2; ++b)
#pragma unroll
            for (int m = 0; m < 4; ++m)
#pragma unroll
                for (int n = 0; n < 2; ++n) acc[a][b][m][n] = (f32x4){0.f, 0.f, 0.f, 0.f};
    bf16x8 At[4][2], B0[2][2], B1[2][2];
    const char* cA = (const char*)g.A + (size_t)cur.pm * tstepA + (size_t)(cur.pn / g.grp_tiles) * K * 2; const char* cB = (const char*)g.Bt + (size_t)cur.pn * tstepB;
    PG8_STAGE(PG8_SB(0, 0), cB, voffB); PG8_STAGE(PG8_SB(0, 1), cB + hstepB, voffB); PG8_STAGE(PG8_SA(0, 0), cA, voffA); PG8_STAGE(PG8_SA(0, 1), cA + hstepA, voffA);
    if (wr == 1) PG8_BAR;
    PG8_WAIT_V(2); PG8_BAR;
    PG8_STAGE(PG8_SB(1, 0), cB + kstep, voffB); PG8_STAGE(PG8_SA(1, 0), cA + kstep, voffA); PG8_STAGE(PG8_SB(1, 1), cB + hstepB + kstep, voffB);
    PG8_WAIT_V(6); PG8_BAR;
    for (;;) {
        const bool has_next = S.next(ui + 1, nxt);
        const char* nA = has_next ? (const char*)g.A + (size_t)nxt.pm * tstepA + (size_t)(nxt.pn / g.grp_tiles) * K * 2 : cA; const char* nB = has_next ? (const char*)g.Bt + (size_t)nxt.pn * tstepB : cB;
        for (int t = 0; t < nt; t += 2) {
            const bool last = (t == nt - 2);
            const char* a1 = cA + (size_t)(t + 1) * kstep;
            const char* a2 = last ? nA : cA + (size_t)(t + 2) * kstep; const char* b2 = last ? nB : cB + (size_t)(t + 2) * kstep;
            const char* a3 = a2 + kstep; const char* b3 = b2 + kstep;
            PG8_LDB(B0, 0, 0); PG8_LDB(B1, 0, 1); PG8_SCHED; PG8_LDA(At, 0, 0); PG8_STAGE(PG8_SA(1, 1), a1 + hstepA, voffA);
            PG8_WAIT_V(8); PG8_WAIT_L(0); PG8_BAR; PG8_MMA(0, 0, At, B0); PG8_MMA(0, 1, At, B1); PG8_BAR; PG8_SCHED;
            PG8_LDA(At, 0, 1); PG8_STAGE(PG8_SB(0, 0), b2, voffB); PG8_STAGE(PG8_SB(0, 1), b2 + hstepB, voffB); PG8_STAGE(PG8_SA(0, 0), a2, voffA);
            PG8_WAIT_V(8); PG8_WAIT_L(0); PG8_BAR; PG8_MMA(1, 0, At, B0); PG8_MMA(1, 1, At, B1); PG8_BAR; PG8_SCHED;
            PG8_LDB(B0, 1, 0); PG8_LDB(B1, 1, 1); PG8_SCHED; PG8_LDA(At, 1, 0); PG8_STAGE(PG8_SA(0, 1), a2 + hstepA, voffA);
            PG8_WAIT_V(8); PG8_WAIT_L(0); PG8_BAR; PG8_MMA(0, 0, At, B0); PG8_MMA(0, 1, At, B1); PG8_BAR; PG8_SCHED;
            PG8_LDA(At, 1, 1); PG8_STAGE(PG8_SB(1, 0), b3, voffB); PG8_STAGE(PG8_SB(1, 1), b3 + hstepB, voffB); PG8_STAGE(PG8_SA(1, 0), a3, voffA);
            PG8_WAIT_V(8); PG8_WAIT_L(0); PG8_BAR; PG8_MMA(1, 0, At, B0); PG8_MMA(1, 1, At, B1); PG8_BAR; PG8_SCHED;
        }
        if constexpr (ALIGN_EPI) { if (wr == 0) PG8_BAR; }
        E(acc, cur, wr, wc, fr, fq);
        if (!has_next) break;
#pragma unroll
        for (int a = 0; a < 2; ++a)
#pragma unroll
            for (int b = 0; b < 2; ++b)
#pragma unroll
                for (int m = 0; m < 4; ++m)
#pragma unroll
                    for (int n = 0; n < 2; ++n) acc[a][b][m][n] = (f32x4){0.f, 0.f, 0.f, 0.f};
        cur = nxt; cA = nA; cB = nB; ++ui;
        if constexpr (ALIGN_EPI) { if (wr == 1) PG8_BAR; }
    }
    PG8_WAIT_V(0);
    if constexpr (!ALIGN_EPI) { if (wr == 0) PG8_BAR; }
    PG8_BAR;
#undef PG8_SA
#undef PG8_SB
#undef PG8_STAGE
#undef PG8_LDA
#undef PG8_LDB
#undef PG8_MMA
#undef PG8_WAIT_V
#undef PG8_WAIT_L
#undef PG8_BAR
#undef PG8_SCHED
}
}

__device__ __forceinline__ void transpose_item(const float* W, int K, int N, bf16_t* WT, int row_base, LAS float* scr, int kb, int nb, int lane) {
    const int k0 = 64 * kb, n0 = 32 * nb;
#pragma unroll 8
    for (int i = 0; i < 32; ++i) { const int kk = 2 * i + (lane >> 5); scr[kk * 33 + (lane & 31)] = W[(size_t)(k0 + kk) * N + n0 + (lane & 31)]; }
    LDS_WAIT();
    const int c = lane & 7;
#pragma unroll
    for (int j = 0; j < 4; ++j) { const int n = (lane >> 3) + 8 * j; const LAS float* s = scr + (8 * c) * 33 + n;
        u32x4 o; o.x = pk2(s[0 * 33], s[1 * 33]); o.y = pk2(s[2 * 33], s[3 * 33]); o.z = pk2(s[4 * 33], s[5 * 33]); o.w = pk2(s[6 * 33], s[7 * 33]);
        *(u32x4*)(WT + (size_t)(row_base + n) * K + k0 + 8 * c) = o; }
    LDS_WAIT();
}

struct Ptrs {
    const float *xp, *xs, *w_in_pool, *w_grp, *scale_pool, *w_out_pool, *w_in_na, *rpb, *w_out_na, *ln_g, *ln_b;
    float* out; unsigned char* ws;
};

__device__ __forceinline__ void p0_convert(const Ptrs& P, LAS unsigned char* lds, int vcu, int G, int wave, int lane) {
    LAS float* scr = (LAS float*)(lds + wave * 16384);
    const int gw = vcu * NWAVES + wave, NGW = G * NWAVES;
    bf16_t* Wt1 = (bf16_t*)(P.ws + WS_W1); bf16_t* Wt2 = (bf16_t*)(P.ws + WS_W2); bf16_t* Wt3 = (bf16_t*)(P.ws + WS_W3); bf16_t* Wt4 = (bf16_t*)(P.ws + WS_W4); bf16_t* Wt5 = (bf16_t*)(P.ws + WS_W5);
    constexpr int I1 = 16 * 128, I2 = 4 * 8 * 16, I3 = 32 * 32, I4 = 16 * 128, I5 = 16 * 32;
    constexpr int NITEMS = I1 + I2 + I3 + I4 + I5;
    for (int it = gw; it < NITEMS; it += NGW) {
        int r = it;
        if (r < I1) { transpose_item(P.w_in_pool, 1024, 4096, Wt1, 32 * (r % 128), scr, r / 128, r % 128, lane); continue; } r -= I1;
        if (r < I2) { const int g = r / 128, q = r % 128; transpose_item(P.w_grp + (size_t)g * 512 * 512, 512, 512, Wt2 + (size_t)g * 512 * 512, 32 * (q % 16), scr, q / 16, q % 16, lane); continue; } r -= I2;
        if (r < I3) { transpose_item(P.w_out_pool, 2048, 1024, Wt3, 32 * (r % 32), scr, r / 32, r % 32, lane); continue; } r -= I3;
        if (r < I4) { const int nb = r % 128, n0 = 32 * nb; const int rb = n0 < 2048 ? n0 : (n0 < 3072 ? n0 + 1024 : n0 - 1024);
            transpose_item(P.w_in_na, 1024, 4096, Wt4, rb, scr, r / 128, nb, lane); continue; } r -= I4;
        transpose_item(P.w_out_na, 1024, 1024, Wt5, 32 * (r % 32), scr, r / 32, r % 32, lane);
    }
    bf16_t* xb = (bf16_t*)(P.ws + WS_R0);
    const size_t nitem = (size_t)T * D / 8, gt = (size_t)(vcu * NTHREADS + wave * 64 + lane), NGT = (size_t)G * NTHREADS;
    for (size_t i = gt; i < nitem; i += NGT) {
        const size_t e = i * 8; const float* src = e < (size_t)TP * D ? P.xp + e : P.xs + (e - (size_t)TP * D);
        const f32x4 a = *(const f32x4*)src, b = *(const f32x4*)(src + 4);
        u32x4 o; o.x = pk2(a[0], a[1]); o.y = pk2(a[2], a[3]); o.z = pk2(b[0], b[1]); o.w = pk2(b[2], b[3]);
        *(u32x4*)(xb + e) = o;
    }
}

__device__ __forceinline__ void load8(const bf16_t* p, float (&v)[8]) { const u32x4 w = *(const u32x4*)p; v[0] = bf_lo(w.x); v[1] = bf_hi(w.x); v[2] = bf_lo(w.y); v[3] = bf_hi(w.y); v[4] = bf_lo(w.z); v[5] = bf_hi(w.z); v[6] = bf_lo(w.w); v[7] = bf_hi(w.w); }
__device__ __forceinline__ void pool_phase(const bf16_t* u, bf16_t* mx, int vcu, int G, int tid) {
    constexpr int CH = 32;
    const int sub = tid >> 8, t8 = tid & 255, g = t8 >> 6, h = 1 << g, c0 = t8 * 8;
    for (int ck = vcu * 2 + sub; ck < T / CH; ck += G * 2) {
        const int t0 = ck * CH;
        int s0, s1; if (t0 < TP) { s0 = t0 & ~8191; s1 = s0 + 8192; } else { s0 = TP + ((t0 - TP) & ~4095); s1 = s0 + 4096; }
        float sum[8], v[8];
#pragma unroll
        for (int j = 0; j < 8; ++j) sum[j] = 0.f;
        const int lo = max(t0 - h, s0), hi = min(t0 + h, s1);
        for (int k = lo; k < hi; ++k) { load8(u + (size_t)k * PW + c0, v);
#pragma unroll
            for (int j = 0; j < 8; ++j) sum[j] += v[j]; }
        for (int t = t0; t < t0 + CH; ++t) {
            const int wl = max(t - h, s0), wh = min(t + h, s1); const float inv = 1.0f / (float)(wh - wl);
            load8(u + (size_t)t * PW + c0, v);
            u32x4 o; o.x = pk2(sum[0] * inv - v[0], sum[1] * inv - v[1]); o.y = pk2(sum[2] * inv - v[2], sum[3] * inv - v[3]);
            o.z = pk2(sum[4] * inv - v[4], sum[5] * inv - v[5]); o.w = pk2(sum[6] * inv - v[6], sum[7] * inv - v[7]);
            *(u32x4*)(mx + (size_t)t * PW + c0) = o;
            if (t + h < s1) { load8(u + (size_t)(t + h) * PW + c0, v);
#pragma unroll
                for (int j = 0; j < 8; ++j) sum[j] += v[j]; }
            if (t - h >= s0) { load8(u + (size_t)(t - h) * PW + c0, v);
#pragma unroll
                for (int j = 0; j < 8; ++j) sum[j] -= v[j]; }
        }
    }
}

__device__ __forceinline__ void ln_phase(const float* y, const float* gam, const float* bet, float* o32, bf16_t* o16, int gw, int NGW, int lane) {
    f32x4 gv[4], bv[4];
#pragma unroll
    for (int j = 0; j < 4; ++j) { gv[j] = ((const f32x4*)gam)[lane + 64 * j]; bv[j] = ((const f32x4*)bet)[lane + 64 * j]; }
    for (int row = gw; row < T; row += NGW) {
        const f32x4* yr = (const f32x4*)(y + (size_t)row * D) + lane;
        f32x4 v[4]; float s = 0.f;
#pragma unroll
        for (int j = 0; j < 4; ++j) { v[j] = yr[64 * j]; s += (v[j][0] + v[j][1]) + (v[j][2] + v[j][3]); }
        const float mean = wave_sum(s) * (1.f / D); float s2 = 0.f;
#pragma unroll
        for (int j = 0; j < 4; ++j) { v[j] = v[j] - mean; s2 += (v[j][0] * v[j][0] + v[j][1] * v[j][1]) + (v[j][2] * v[j][2] + v[j][3] * v[j][3]); }
        const float rstd = 1.f / sqrtf(wave_sum(s2) * (1.f / D) + LN_EPS);
#pragma unroll
        for (int j = 0; j < 4; ++j) { const f32x4 o = v[j] * rstd * gv[j] + bv[j];
            if (o32) ((f32x4*)(o32 + (size_t)row * D))[lane + 64 * j] = o;
            if (o16) { u32x2 w; w.x = pk2(o[0], o[1]); w.y = pk2(o[2], o[3]); ((u32x2*)(o16 + (size_t)row * D))[lane + 64 * j] = w; } }
    }
}

constexpr int NA_VOFF = 65536, NA_VPITCH = 1040, NA_BOFF = NA_VOFF + 64 * NA_VPITCH;
__device__ __forceinline__ void na_phase(LAS unsigned char* lds, const bf16_t* q, const bf16_t* k, const bf16_t* vt, const bf16_t* sg, const float* rpb, bf16_t* og, int bid, int G, int wave, int lane, int tid) {
    const int fr = lane & 15, fq = lane >> 4, hd2 = wave >> 2, j = wave & 3;
    LAS float* btab = (LAS float*)(lds + NA_BOFF + hd2 * 2048) + 16;
    const int c = 16 * j + fr, cstart = min(max(c - 8, 0), 48);
    const int cs0 = j == 0 ? 0 : (j == 1 ? 8 : (j == 2 ? 24 : 32));
    const int kc0 = cs0 + fq * 4, dcb = kc0 - c + 15;
    int koff[2];
#pragma unroll
    for (int hf = 0; hf < 2; ++hf) { const int tok = cs0 + hf * 16 + fr; koff[hf] = tok * 128 + (((hd2 * 4 + fq) ^ ((tok >> 1) & 7)) << 4); }
    const int voff = NA_VOFF + (hd2 * 32 + fr) * NA_VPITCH + (cs0 + fq * 4) * 2;
    const int st_r = tid >> 3, st_c = tid & 7;
    const int kst = st_r * 128 + ((st_c ^ ((st_r >> 1) & 7)) << 4), vst = NA_VOFF + st_r * NA_VPITCH + st_c * 16;
    for (int strip = bid; strip < 1280; strip += G) {
        const int hp = strip & 15, R0 = (strip >> 4) * 16, h = hp * 2 + hd2;
        int rows, rbase; if (R0 < 1024) { rows = 128; rbase = R0 & ~127; } else { rows = 64; rbase = 1024 + ((R0 - 1024) & ~63); }
        const bf16_t* kg = k + (size_t)st_r * D + hp * 64 + st_c * 8;
        const bf16_t* vg = vt + (size_t)(hp * 64 + st_r) * T + st_c * 8;
        __syncthreads();
        for (int e = tid; e < 2 * 465; e += NTHREADS) { const int hh = e >= 465 ? 1 : 0, ee = e - hh * 465; ((LAS float*)(lds + NA_BOFF + hh * 2048))[16 + ee] = rpb[(2 * hp + hh) * 465 + ee] * LOG2E; }
        int loaded_hi;
        { const int r = R0 - rbase, rs = min(max(r - 4, 0), rows - 8), Rs = rbase + rs;
#pragma unroll
          for (int i = 0; i < 8; ++i) { const int kr = Rs + i, slot = kr & 7;
              const u32x4 a = *(const u32x4*)(kg + (size_t)kr * 64 * D), b = *(const u32x4*)(vg + (size_t)kr * 64);
              *(LAS u32x4*)(lds + slot * 8192 + kst) = a; *(LAS u32x4*)(lds + vst + slot * 128) = b; }
          loaded_hi = Rs + 8; }
        __syncthreads();
        for (int R = R0; R < R0 + 16; ++R) {
            const int r = R - rbase, rs = min(max(r - 4, 0), rows - 8), Rs = rbase + rs, drb = rs - r + 7;
            bool pf = false; u32x4 pka = {0u, 0u, 0u, 0u}, pva = {0u, 0u, 0u, 0u};
            if (R + 1 < R0 + 16) { const int rs1 = min(max(r + 1 - 4, 0), rows - 8);
                if (rbase + rs1 + 8 > loaded_hi) { pf = true; pka = *(const u32x4*)(kg + (size_t)loaded_hi * 64 * D); pva = *(const u32x4*)(vg + (size_t)loaded_hi * 64); } }
            const size_t tq = (size_t)R * 64 + c;
            const bf16x8 qv = *(const bf16x8*)(q + tq * D + h * HD + fq * 8);
            f32x4 S[8][2];
#pragma unroll
            for (int i = 0; i < 8; ++i) { const int slot = (Rs + i) & 7;
#pragma unroll
                for (int hf = 0; hf < 2; ++hf) { const bf16x8 kv = *(const LAS bf16x8*)(lds + slot * 8192 + koff[hf]);
                    S[i][hf] = __builtin_amdgcn_mfma_f32_16x16x32_bf16(kv, qv, (f32x4){0.f, 0.f, 0.f, 0.f}, 0, 0, 0); } }
            float mx = -3.0e38f;
#pragma unroll
            for (int i = 0; i < 8; ++i)
#pragma unroll
                for (int hf = 0; hf < 2; ++hf)
#pragma unroll
                    for (int jj = 0; jj < 4; ++jj) { const int kc = kc0 + hf * 16 + jj; const bool valid = (kc >= cstart) && (kc < cstart + 16);
                        const float b = btab[(drb + i) * 31 + dcb + hf * 16 + jj];
                        const float s = valid ? S[i][hf][jj] + b : -3.0e38f; S[i][hf][jj] = s; mx = fmaxf(mx, s); }
            mx = fmaxf(mx, __shfl_xor(mx, 16)); mx = fmaxf(mx, __shfl_xor(mx, 32));
            float sum = 0.f;
#pragma unroll
            for (int i = 0; i < 8; ++i)
#pragma unroll
                for (int hf = 0; hf < 2; ++hf)
#pragma unroll
                    for (int jj = 0; jj < 4; ++jj) { const float p = __builtin_amdgcn_exp2f(S[i][hf][jj] - mx); S[i][hf][jj] = p; sum += p; }
            sum += __shfl_xor(sum, 16); sum += __shfl_xor(sum, 32);
            f32x4 O[2] = {(f32x4){0.f, 0.f, 0.f, 0.f}, (f32x4){0.f, 0.f, 0.f, 0.f}};
#pragma unroll
            for (int i = 0; i < 8; ++i) { const int slot = (Rs + i) & 7;
                u32x4 pw; pw.x = pk2(S[i][0][0], S[i][0][1]); pw.y = pk2(S[i][0][2], S[i][0][3]); pw.z = pk2(S[i][1][0], S[i][1][1]); pw.w = pk2(S[i][1][2], S[i][1][3]);
                const bf16x8 pv = __builtin_bit_cast(bf16x8, pw);
#pragma unroll
                for (int dt = 0; dt < 2; ++dt) { const LAS unsigned char* vp = lds + voff + dt * 16 * NA_VPITCH + slot * 128;
                    const u32x2 lo = *(const LAS u32x2*)vp, hi = *(const LAS u32x2*)(vp + 32);
                    u32x4 vw; vw.x = lo.x; vw.y = lo.y; vw.z = hi.x; vw.w = hi.y;
                    O[dt] = __builtin_amdgcn_mfma_f32_16x16x32_bf16(__builtin_bit_cast(bf16x8, vw), pv, O[dt], 0, 0, 0); }
            }
            const float inv = 1.0f / sum;
#pragma unroll
            for (int dt = 0; dt < 2; ++dt) { const size_t off = tq * D + h * HD + dt * 16 + fq * 4;
                const u32x2 gw = *(const u32x2*)(sg + off);
                u32x2 w; w.x = pk2(O[dt][0] * inv * bf_lo(gw.x), O[dt][1] * inv * bf_hi(gw.x)); w.y = pk2(O[dt][2] * inv * bf_lo(gw.y), O[dt][3] * inv * bf_hi(gw.y));
                *(u32x2*)(og + off) = w; }
            __syncthreads();
            if (pf) { const int slot = loaded_hi & 7; *(LAS u32x4*)(lds + slot * 8192 + kst) = pka; *(LAS u32x4*)(lds + vst + slot * 128) = pva; ++loaded_hi; }
            __syncthreads();
        }
    }
}

struct Args { const float* in[11]; float* out; unsigned char* ws; int ph_lo, ph_hi; };

__global__ void __launch_bounds__(NTHREADS, 2) mk_fwd(Args args) {
    extern __shared__ __attribute__((aligned(16))) unsigned char lds_raw[];
    LAS unsigned char* lds = (LAS unsigned char*)lds_raw;
    const int tid = threadIdx.x, lane = tid & 63, wave = __builtin_amdgcn_readfirstlane(tid >> 6);
    const int G = gridDim.x, bx = blockIdx.x;
    const int vcu = (G % 8 == 0) ? (bx % 8) * (G / 8) + bx / 8 : bx;
    Ptrs P; P.xp = args.in[0]; P.xs = args.in[1]; P.w_in_pool = args.in[2]; P.w_grp = args.in[3]; P.scale_pool = args.in[4]; P.w_out_pool = args.in[5];
    P.w_in_na = args.in[6]; P.rpb = args.in[7]; P.w_out_na = args.in[8]; P.ln_g = args.in[9]; P.ln_b = args.in[10]; P.out = args.out; P.ws = args.ws;
    unsigned char* ws = args.ws;
    bf16_t* R0 = (bf16_t*)(ws + WS_R0); bf16_t* R1 = (bf16_t*)(ws + WS_R1); bf16_t* R2 = (bf16_t*)(ws + WS_R2);
    bf16_t* OUTB = (bf16_t*)args.out;
    bf16_t* Wt1 = (bf16_t*)(ws + WS_W1); bf16_t* Wt2 = (bf16_t*)(ws + WS_W2); bf16_t* Wt3 = (bf16_t*)(ws + WS_W3); bf16_t* Wt4 = (bf16_t*)(ws + WS_W4); bf16_t* Wt5 = (bf16_t*)(ws + WS_W5);
    const int lo = args.ph_lo, hi = args.ph_hi;
#define IN(k) (lo <= (k) && (k) < hi)
#define REPS(k) for (int rep_ = 0; rep_ < ((((MK_REP) >> (k)) & 1) ? 2 : 1); ++rep_)
#define SEAM(k) do { if (IN(k) && IN((k) + 1)) { cg::this_grid().sync(); } } while (0)
    constexpr int NOGRP = 1 << 30;

    if (IN(0)) REPS(0) { p0_convert(P, lds, vcu, G, wave, lane); __syncthreads(); }
    SEAM(0);
    if (IN(1)) REPS(1) {
        pg8::Gemm g{R0, Wt1, T, 4096, 1024, 1024, 1024, NOGRP}; pg8::StaticOrder S; S.init(T, 4096, G, bx);
        pg8::EpiBf16 E{R1, (long)(R2 - R1), 0, PW, 8, 1, 1.0f};
        pg8::gemm_phase<pg8::EpiBf16>(lds, g, S, E);
    }
    SEAM(1);
    if (IN(2)) REPS(2) pool_phase(R1, OUTB, vcu, G, tid);
    SEAM(2);
    if (IN(3)) REPS(3) {
        pg8::Gemm g{OUTB, Wt2, T, 2048, 512, PW, 512, 2}; pg8::StaticOrder S; S.init(T, 2048, G, bx);
        pg8::EpiGate E{R1, R2, P.scale_pool, PW};
        pg8::gemm_phase<pg8::EpiGate>(lds, g, S, E);
    }
    SEAM(3);
    if (IN(4)) REPS(4) {
        pg8::Gemm g{R1, Wt3, T, 1024, 2048, PW, 2048, NOGRP}; pg8::StaticOrder S; S.init(T, 1024, G, bx);
        pg8::EpiRes E{P.out, P.xp, P.xs, TP, D};
        pg8::gemm_phase<pg8::EpiRes>(lds, g, S, E);
    }
    SEAM(4);
    if (IN(5)) REPS(5) ln_phase(P.out, P.ln_g, P.ln_b, (float*)R2, R0, vcu * NWAVES + wave, G * NWAVES, lane);
    SEAM(5);
    if (IN(6)) REPS(6) {
        { pg8::Gemm g{R0, Wt4, T, 3072, 1024, 1024, 1024, NOGRP}; pg8::StaticOrder S; S.init(T, 3072, G, bx);
          pg8::EpiBf16 E{R1, (long)T * D, (long)(OUTB - R1), D, 4, 2, NA_QSCALE};
          pg8::gemm_phase<pg8::EpiBf16>(lds, g, S, E); }
        { pg8::Gemm g{Wt4 + (size_t)3072 * 1024, R0, 1024, T, 1024, 1024, 1024, NOGRP}; pg8::StaticOrder S; S.init(1024, T, G, bx);
          pg8::EpiBf16 E{OUTB + (size_t)T * D, 0, 0, T, NOGRP, -1, 1.0f};
          pg8::gemm_phase<pg8::EpiBf16>(lds, g, S, E); }
    }
    SEAM(6);
    if (IN(7)) REPS(7) na_phase(lds, R1, R1 + (size_t)T * D, OUTB + (size_t)T * D, OUTB, P.rpb, R0, bx, G, wave, lane, tid);
    SEAM(7);
    if (IN(8)) REPS(8) {
        pg8::Gemm g{R0, Wt5, T, 1024, 1024, 1024, 1024, NOGRP}; pg8::StaticOrder S; S.init(T, 1024, G, bx);
        pg8::EpiRes E{P.out, (const float*)R2, (const float*)R2, 0, D};
        pg8::gemm_phase<pg8::EpiRes>(lds, g, S, E);
    }
    SEAM(8);
    if (IN(9)) ln_phase(P.out, P.ln_g + D, P.ln_b + D, P.out, nullptr, vcu * NWAVES + wave, G * NWAVES, lane);
#undef IN
#undef SEAM
}

extern "C" void kernel_launch(void* const* d_in, const int* in_sizes, int n_in, void* d_out, int out_size, void* d_ws, size_t ws_size, hipStream_t stream) {
    static int grid = 0;
    if (grid == 0) {
        if (n_in != 11 || out_size != T * D || ws_size < WS_END) { fprintf(stderr, "kernel_launch: unexpected shapes (n_in %d, out %d, ws %zu)\n", n_in, out_size, ws_size); grid = -1; return; }
        int dev = 0, cus = 0, per_cu = 0;
        hipGetDevice(&dev); hipDeviceGetAttribute(&cus, hipDeviceAttributeMultiprocessorCount, dev);
        if (hipFuncSetAttribute((const void*)mk_fwd, hipFuncAttributeMaxDynamicSharedMemorySize, LDS_BYTES) != hipSuccess) { fprintf(stderr, "kernel_launch: hipFuncSetAttribute failed\n"); grid = -1; return; }
        hipOccupancyMaxActiveBlocksPerMultiprocessor(&per_cu, (const void*)mk_fwd, NTHREADS, LDS_BYTES);
        (void)hipGetLastError();
        if (per_cu < 1) per_cu = 1;
        grid = cus * 1;
        fprintf(stderr, "kernel_launch: cus %d per_cu %d grid %d\n", cus, per_cu, grid);
    }
    if (grid < 0) return;
    Args a{};
    for (int i = 0; i < 11; ++i) a.in[i] = (const float*)d_in[i];
    a.out = (float*)d_out; a.ws = (unsigned char*)d_ws;
#if MK_ONE_LAUNCH
    a.ph_lo = 0; a.ph_hi = 10;
    void* kargs[] = {&a};
    hipError_t e = hipLaunchCooperativeKernel((const void*)mk_fwd, dim3(grid), dim3(NTHREADS), kargs, LDS_BYTES, stream);
    if (e != hipSuccess) fprintf(stderr, "kernel_launch: cooperative launch failed: %s\n", hipGetErrorString(e));
#else
    for (int ph = 0; ph < 10; ++ph) { a.ph_lo = ph; a.ph_hi = ph + 1; hipLaunchKernelGGL(mk_fwd, dim3(grid), dim3(NTHREADS), LDS_BYTES, stream, a); }
#endif
}
```
